# Optimizing an MI355X kernel written in HIP

```python
import math
import jax, jax.numpy as jnp
from jax import lax
import numpy as np

D_MODEL = 1024
BATCH = 2
SEQ = 8192
DEPTH = 2

HG_HEADS = 4
HG_DK = 128
HG_DV = 128
HG_WIDTH = HG_HEADS * HG_DK
HG_CHUNK = 64
DA_HEADS = 4
DA_DQK = 64
DA_DV = 2 * DA_DQK
DA_WIDTH = DA_HEADS * DA_DV
DA_QBLOCK = 128
ALIBI_MAX_BIAS = 8.0
D_FF = ((8 * D_MODEL // 3 + 255) // 256) * 256
N_BRANCH = 2
EPS = 1e-6
IN_SIZES = (HG_HEADS * HG_DK, HG_HEADS * HG_DK, HG_HEADS * HG_DV, HG_HEADS * HG_DV,
            DA_HEADS * 2 * DA_DQK, DA_HEADS * 2 * DA_DQK, DA_HEADS * DA_DV,
            N_BRANCH * D_MODEL)
D_IN = sum(IN_SIZES)

kernel_name = "hybrid_hgrn2_diffattn_gated_block"


def _split_points():
    return tuple(int(v) for v in np.cumsum(np.array(IN_SIZES))[:-1])


def rmsnorm(x, gain):
    xf = x.astype(jnp.float32)
    y = xf * lax.rsqrt(jnp.mean(xf * xf, axis=-1, keepdims=True) + EPS)
    return (y * gain.astype(jnp.float32)).astype(x.dtype)


def hgrn2_mix(q_raw, f_raw, i_raw, g_raw, lb, out_gain):
    B, S, _ = q_raw.shape
    f32 = jnp.float32
    lb = lb.astype(f32)
    z = f_raw.astype(f32)
    log_f = jnp.logaddexp(jnp.log(lb), jnp.log1p(-lb) + jax.nn.log_sigmoid(z))
    k = (1.0 - lb) * jax.nn.sigmoid(-z)
    q = jax.nn.silu(q_raw.astype(f32))
    v = i_raw.astype(f32)
    n = S // HG_CHUNK

    def to_chunks(t, d):
        return t.reshape(B, n, HG_CHUNK, HG_HEADS, d).transpose(1, 0, 3, 2, 4)

    causal = jnp.tril(jnp.ones((HG_CHUNK, HG_CHUNK), dtype=bool))

    def step(state, xs):
        qc, kc, vc, lfc = xs
        b = jnp.cumsum(lfc, axis=-2)
        rel = b[..., :, None, :] - b[..., None, :, :]
        decay = jnp.exp(jnp.where(causal[:, :, None], rel, -jnp.inf))
        scores = jnp.einsum('bhtd,bhtsd,bhsd->bhts', qc, decay, kc)
        o = jnp.einsum('bhts,bhse->bhte', scores, vc) + jnp.einsum('bhtd,bhde->bhte', qc * jnp.exp(b), state)
        b_last = b[..., -1:, :]
        new_state = jnp.exp(b_last[..., 0, :])[..., None] * state + jnp.einsum(
            'bhsd,bhse->bhde', kc * jnp.exp(b_last - b), vc)
        return new_state, o

    s0 = jnp.zeros((B, HG_HEADS, HG_DK, HG_DV), f32)
    _, o = lax.scan(step, s0, (to_chunks(q, HG_DK), to_chunks(k, HG_DK),
                               to_chunks(v, HG_DV), to_chunks(log_f, HG_DK)))
    o = o.transpose(1, 0, 3, 2, 4).reshape(B, S, HG_HEADS, HG_DV)
    g = jax.nn.silu(g_raw.astype(f32)).reshape(B, S, HG_HEADS, HG_DV)
    o = rmsnorm(o, out_gain) * g
    return o.reshape(B, S, HG_HEADS * HG_DV).astype(q_raw.dtype)


def diff_attention(q_raw, k_raw, v_raw, lam, lam_init, subln_gain):
    B, S, _ = q_raw.shape
    f32 = jnp.float32
    q = q_raw.reshape(B, S, DA_HEADS, 2, DA_DQK).transpose(0, 2, 3, 1, 4)
    k = k_raw.reshape(B, S, DA_HEADS, 2, DA_DQK).transpose(0, 2, 3, 1, 4)
    v = v_raw.reshape(B, S, DA_HEADS, DA_DV).transpose(0, 2, 1, 3)
    nb = S // DA_QBLOCK
    qb = q.reshape(B, DA_HEADS, 2, nb, DA_QBLOCK, DA_DQK).transpose(3, 0, 1, 2, 4, 5)
    slopes = jnp.exp2(-ALIBI_MAX_BIAS / DA_HEADS * jnp.arange(1, DA_HEADS + 1, dtype=f32))
    key_pos = jnp.arange(S)
    scale = 1.0 / math.sqrt(DA_DQK)

    def block(args):
        qblk, idx = args
        s = jnp.einsum('bhcqd,bhckd->bhcqk', qblk, k).astype(f32) * scale
        dist = (idx * DA_QBLOCK + jnp.arange(DA_QBLOCK))[:, None] - key_pos[None, :]
        alibi = slopes[:, None, None] * dist.astype(f32)[None]
        s = jnp.where(dist >= 0, s - alibi[None, :, None], -jnp.inf)
        p = jax.nn.softmax(s, axis=-1)
        p = p[:, :, 0] - lam * p[:, :, 1]
        return jnp.einsum('bhqk,bhke->bhqe', p.astype(v.dtype), v)

    o = lax.map(block, (qb, jnp.arange(nb)))
    o = o.transpose(1, 0, 3, 2, 4).reshape(B, S, DA_HEADS, DA_DV)
    o = rmsnorm(o, subln_gain) * (1.0 - lam_init)
    return o.reshape(B, S, DA_WIDTH).astype(q_raw.dtype)


def setup_inputs(seed: int = 0) -> dict:
    key = jax.random.key(seed)
    ks = jax.random.split(key, 20)
    nrm = jax.random.normal

    def w(k, shape, fan_in):
        return nrm(k, shape, jnp.float32) * fan_in ** -0.5

    def gain(k, shape):
        return 1.0 + 0.02 * nrm(k, shape, jnp.float32)

    return {
        "x": nrm(ks[0], (BATCH, SEQ, D_MODEL), jnp.float32),
        "lower_bounds": 0.1 * nrm(ks[1], (DEPTH, HG_WIDTH), jnp.float32),
        "norm_mix_pre": gain(ks[2], (DEPTH, D_MODEL)),
        "norm_mix_post": gain(ks[3], (DEPTH, D_MODEL)),
        "norm_ffn_pre": gain(ks[4], (DEPTH, D_MODEL)),
        "norm_ffn_post": gain(ks[5], (DEPTH, D_MODEL)),
        "w_in": w(ks[6], (DEPTH, D_MODEL, D_IN), D_MODEL),
        "hg_out_norm": gain(ks[7], (DEPTH, HG_DV)),
        "da_subln": gain(ks[8], (DEPTH, DA_DV)),
        "lambda_q1": 0.1 * nrm(ks[9], (DEPTH, DA_DQK), jnp.float32),
        "lambda_k1": 0.1 * nrm(ks[10], (DEPTH, DA_DQK), jnp.float32),
        "lambda_q2": 0.1 * nrm(ks[11], (DEPTH, DA_DQK), jnp.float32),
        "lambda_k2": 0.1 * nrm(ks[12], (DEPTH, DA_DQK), jnp.float32),
        "w_up_a": w(ks[13], (DEPTH, HG_WIDTH, D_MODEL), HG_WIDTH),
        "w_up_b": w(ks[14], (DEPTH, DA_WIDTH, D_MODEL), DA_WIDTH),
        "w_out": w(ks[15], (DEPTH, D_MODEL, D_MODEL), D_MODEL),
        "w_ffn_gate": w(ks[16], (DEPTH, D_MODEL, D_FF), D_MODEL),
        "w_ffn_up": w(ks[17], (DEPTH, D_MODEL, D_FF), D_MODEL),
        "w_ffn_down": w(ks[18], (DEPTH, D_FF, D_MODEL), D_FF),
    }


def reference(x, lower_bounds, norm_mix_pre, norm_mix_post, norm_ffn_pre, norm_ffn_post,
              w_in, hg_out_norm, da_subln, lambda_q1, lambda_k1, lambda_q2, lambda_k2,
              w_up_a, w_up_b, w_out, w_ffn_gate, w_ffn_up, w_ffn_down):
    f32 = jnp.float32
    lb_all = jnp.cumsum(jax.nn.softmax(lower_bounds.astype(f32), axis=0), axis=0)
    lb_all = lb_all - lb_all[0:1]
    split_pts = _split_points()
    for l in range(DEPTH):
        h = rmsnorm(x, norm_mix_pre[l])
        proj = jnp.einsum('bsd,de->bse', h, w_in[l])
        q_a, f_a, i_a, g_a, q_b, k_b, v_b, gate_raw = jnp.split(proj, split_pts, axis=-1)
        y_a = hgrn2_mix(q_a, f_a, i_a, g_a, lb_all[l], hg_out_norm[l])
        lam_init = 0.8 - 0.6 * math.exp(-0.3 * l)
        lam = (jnp.exp(jnp.sum(lambda_q1[l].astype(f32) * lambda_k1[l].astype(f32)))
               - jnp.exp(jnp.sum(lambda_q2[l].astype(f32) * lambda_k2[l].astype(f32))) + lam_init)
        y_b = diff_attention(q_b, k_b, v_b, lam, lam_init, da_subln[l])
        gate_a, gate_b = jnp.split(jax.nn.sigmoid(gate_raw), N_BRANCH, axis=-1)
        merged = (gate_a * jnp.einsum('bsc,cd->bsd', y_a, w_up_a[l])
                  + gate_b * jnp.einsum('bsc,cd->bsd', y_b, w_up_b[l]))
        mix = jnp.einsum('bsd,de->bse', merged, w_out[l])
        x = x + rmsnorm(mix, norm_mix_post[l])
        h = rmsnorm(x, norm_ffn_pre[l])
        ff = jax.nn.silu(jnp.einsum('bsd,df->bsf', h, w_ffn_gate[l])) * jnp.einsum('bsd,df->bsf', h, w_ffn_up[l])
        ff = jnp.einsum('bsf,fd->bsd', ff, w_ffn_down[l])
        x = x + rmsnorm(ff, norm_ffn_post[l])
    return x
```

```cpp
#include <hip/hip_runtime.h>
#include <cstdio>
#include <cstdint>
#include <cmath>

constexpr int BATCH = 2, SEQ = 8192, D = 1024, M = BATCH * SEQ, DEPTH = 2;
constexpr int HGH = 4, HGDK = 128, HGDV = 128, HGW = 512;
constexpr int DAH = 4, DQK = 64, DADV = 128, DAW = 512;
constexpr int DFF = 2816, DIN = 5632, NMIX = 3584, NGATE = 2048;
constexpr float EPS = 1e-6f;
constexpr float LOG2E = 1.4426950408889634f;
constexpr float C2 = 0.125f * LOG2E;

constexpr size_t MiB = 1u << 20;
constexpr size_t WS_CTL = 0, CTL_ZERO_BYTES = 256 * 1024;
constexpr size_t WS_W = 256 * 1024;
constexpr size_t WO_IN = 0, WO_UP = WO_IN + (size_t)DIN * D * 2, WO_OUT = WO_UP + (size_t)D * D * 2, WO_GU = WO_OUT + (size_t)D * D * 2, WO_DN = WO_GU + (size_t)2 * DFF * D * 2, WO_END = WO_DN + (size_t)D * DFF * 2;
static_assert(WS_W + WO_END <= 31 * MiB + 768 * 1024, "weights");
constexpr size_t WS_XCH = 31 * MiB + 768 * 1024;
constexpr size_t WS_XN = 32 * MiB;
constexpr size_t WS_QA = 64 * MiB, WS_LF = 80 * MiB, WS_VA = 112 * MiB, WS_GA = 128 * MiB, WS_QB = 144 * MiB, WS_KB = 160 * MiB, WS_VB = 176 * MiB;
constexpr size_t WS_YAB = 192 * MiB;
constexpr size_t WS_OB = 224 * MiB;
constexpr size_t WS_GATE = 64 * MiB;
constexpr size_t WS_MERGED = 128 * MiB;
constexpr size_t WS_FF = 64 * MiB;
constexpr size_t WS_TMP1 = 64 * MiB;
constexpr size_t WS_TMP2 = 160 * MiB;
constexpr size_t WS_END = 256 * MiB;

constexpr int CW_BAR = 4096;

constexpr int RING_BYTES = 131072;
constexpr int LDSCTL_OFF = RING_BYTES, MISC_OFF = LDSCTL_OFF + 320;
constexpr int LDS_BYTES = 147456;
constexpr int NWAVES = 8, NTHREADS = 512;

#define GAS __attribute__((address_space(1)))
#define LAS __attribute__((address_space(3)))
typedef unsigned short bf16;
typedef unsigned v4u __attribute__((ext_vector_type(4)));
typedef unsigned v2u __attribute__((ext_vector_type(2)));
typedef float f32x4 __attribute__((ext_vector_type(4)));
typedef GAS unsigned gu32;
#define RLX_AGENT __ATOMIC_RELAXED, __HIP_MEMORY_SCOPE_AGENT
#define LDS_WAIT() asm volatile("s_waitcnt lgkmcnt(0)" ::: "memory")
#define VM_WAIT() asm volatile("s_waitcnt vmcnt(0)" ::: "memory")

__device__ __forceinline__ unsigned f2bf(float f) { unsigned u = __builtin_bit_cast(unsigned, f); return (u + 0x7fffu + ((u >> 16) & 1u)) >> 16; }
__device__ __forceinline__ unsigned pk2(float lo, float hi) { return f2bf(lo) | (f2bf(hi) << 16); }
__device__ __forceinline__ float bf2f(unsigned short b) { return __builtin_bit_cast(float, (unsigned)b << 16); }
__device__ __forceinline__ float sigmoidf_(float x) { return 1.0f / (1.0f + __expf(-x)); }
__device__ __forceinline__ float siluf_(float x) { return x / (1.0f + __expf(-x)); }

#define XB_TMO      128
#define XB_XCNT(j)  (256  + 64 * (j))
#define XB_XSUB(j)  (1280 + 64 * (j))
#define XB_XGEN(j)  (2304 + 64 * (j))
#define XB_TOP      3328
#define XB_TOPGEN   3392
#define XCD_BAR_WORDS 3456
#define XB_SPIN_CAP (1u << 22)
__device__ __forceinline__ unsigned xb_ld(unsigned* p)              { return __hip_atomic_load(p, __ATOMIC_RELAXED, __HIP_MEMORY_SCOPE_AGENT); }
__device__ __forceinline__ unsigned xb_add(unsigned* p, unsigned v) { return __hip_atomic_fetch_add(p, v, __ATOMIC_RELAXED, __HIP_MEMORY_SCOPE_AGENT); }
__device__ __forceinline__ unsigned xb_xcc_id() { return (unsigned)__builtin_amdgcn_s_getreg((3 << 11) | 20) & 0xFu; }
#define XB_SPIN(cond, bar) do { unsigned _sp = 0; while (cond) { __builtin_amdgcn_s_sleep(1); \
    if ((++_sp & 255u) == 0u) { if (xb_ld(&(bar)[XB_TMO])) break; if (_sp > XB_SPIN_CAP) { atomicAdd(&(bar)[XB_TMO], 1u); break; } } } } while (0)
struct XcdBarrier { unsigned* bar; unsigned x; volatile LAS unsigned* st; };
__device__ __forceinline__ XcdBarrier xcd_barrier_post(unsigned* bar, volatile LAS unsigned* st) {
    XcdBarrier b; b.bar = bar; b.x = xb_xcc_id(); b.st = st;
    if (threadIdx.x == 0) (void)xb_add(&bar[XB_XCNT(b.x)], 1u);
    return b;
}
__device__ __forceinline__ void xcd_barrier_complete(unsigned* bar, unsigned x, unsigned& nloc, unsigned& nx) {
    const unsigned G = gridDim.x * gridDim.y * gridDim.z;
    unsigned sum, cnt, mine, sp = 0u;
    for (;;) {
        sum = 0u; cnt = 0u; mine = 0u;
#pragma unroll
        for (unsigned j = 0; j < 16; ++j) { const unsigned c = xb_ld(&bar[XB_XCNT(j)]); sum += c; cnt += (c > 0u) ? 1u : 0u; mine = (j == x) ? c : mine; }
        if (sum == G) break;
        __builtin_amdgcn_s_sleep(1);
        if ((++sp & 255u) == 0u) { if (xb_ld(&bar[XB_TMO])) break; if (sp > XB_SPIN_CAP) { atomicAdd(&bar[XB_TMO], 1u); break; } }
    }
    nloc = mine > 0u ? mine : 1u; nx = cnt > 0u ? cnt : 1u;
}
__device__ __forceinline__ void xcd_barrier(const XcdBarrier& b) {
    asm volatile("s_waitcnt vmcnt(0)" ::: "memory");
    __syncthreads();
    if (threadIdx.x == 0) {
        unsigned* bar = b.bar;
        __builtin_amdgcn_s_waitcnt(0);
        unsigned nloc = b.st[0], nx = b.st[1];
        if (nloc == 0u) { xcd_barrier_complete(bar, b.x, nloc, nx); b.st[0] = nloc; b.st[1] = nx; }
        const unsigned old = xb_add(&bar[XB_XSUB(b.x)], 1u);
        const unsigned gen = old / nloc;
        if (old + 1u == (gen + 1u) * nloc) {
            __builtin_amdgcn_fence(__ATOMIC_RELEASE, "agent");
            asm volatile("s_waitcnt vmcnt(0)" ::: "memory");
            const unsigned og = xb_add(&bar[XB_TOP], 1u);
            const unsigned tg = og / nx;
            if (og + 1u == (tg + 1u) * nx) xb_add(&bar[XB_TOPGEN], 1u);
            else XB_SPIN(xb_ld(&bar[XB_TOPGEN]) == tg, bar);
            __builtin_amdgcn_fence(__ATOMIC_ACQUIRE, "agent");
            xb_add(&bar[XB_XGEN(b.x)], 1u);
            asm volatile("s_waitcnt vmcnt(0)" ::: "memory");
        } else {
            XB_SPIN(xb_ld(&bar[XB_XGEN(b.x)]) == gen, bar);
            __builtin_amdgcn_fence(__ATOMIC_ACQUIRE, "agent");
            asm volatile("s_waitcnt vmcnt(0)" ::: "memory");
        }
    }
    __syncthreads();
}

struct Args { const float* in[19]; float* out; unsigned char* ws; int pad0, pad1; };
typedef const __attribute__((address_space(4))) Args* kargs_t;
__device__ __forceinline__ kargs_t kargs() { unsigned long long p = (unsigned long long)__builtin_amdgcn_kernarg_segment_ptr(); asm volatile("" : "+s"(p)); return (kargs_t)p; }
#define KA (kargs())
struct Frame {
    LAS unsigned char* lds; unsigned char* ldsg;
    volatile LAS unsigned* MISC;
    gu32* ctl;
    int tid, lane, wave, vcu, G;
};
__device__ __forceinline__ float wave_sum(float v) {
#pragma unroll
    for (int o = 1; o < 64; o <<= 1) v += __shfl_xor(v, o);
    return v;
}

__device__ __forceinline__ void transpose_item(const float* W, int N, bf16* WT, int ldk, int koff, int drow0, int k0, int n0, LAS float* scr, int lane) {
#pragma unroll 8
    for (int i = 0; i < 32; ++i) { const int kk = 2 * i + (lane >> 5); scr[kk * 33 + (lane & 31)] = W[(size_t)(k0 + kk) * N + n0 + (lane & 31)]; }
    LDS_WAIT(); asm volatile("" ::: "memory");
    const int c = lane & 7;
#pragma unroll
    for (int j = 0; j < 4; ++j) { const int n = (lane >> 3) + 8 * j; const LAS float* s = scr + (8 * c) * 33 + n;
        v4u o; o.x = pk2(s[0 * 33], s[1 * 33]); o.y = pk2(s[2 * 33], s[3 * 33]); o.z = pk2(s[4 * 33], s[5 * 33]); o.w = pk2(s[6 * 33], s[7 * 33]);
        *(GAS v4u*)(WT + (size_t)(drow0 + n) * ldk + koff + k0 + 8 * c) = o; }
    LDS_WAIT(); asm volatile("" ::: "memory");
}
__device__ __forceinline__ void convert_weights(Frame& F, int l, int which) {
    __syncthreads();
    LAS float* scr = (LAS float*)(F.lds + F.wave * 16384);
    const int gw = F.vcu * NWAVES + F.wave, NGW = F.G * NWAVES;
    bf16* Wb = (bf16*)(KA->ws + WS_W);
    constexpr int I_IN = (D / 64) * (DIN / 32), I_UPA = (HGW / 64) * (D / 32), I_UPB = I_UPA, I_OUT = (D / 64) * (D / 32);
    constexpr int I_G = (D / 64) * (DFF / 32), I_U = I_G, I_D = (DFF / 64) * (D / 32);
    if (which & 1) {
        const float* w_in = KA->in[6] + (size_t)l * D * DIN; const float* w_upa = KA->in[13] + (size_t)l * HGW * D; const float* w_upb = KA->in[14] + (size_t)l * DAW * D; const float* w_out = KA->in[15] + (size_t)l * D * D;
        for (int it = gw; it < I_IN + I_UPA + I_UPB + I_OUT; it += NGW) {
            int r = it;
            if (r < I_IN) { const int nblk = DIN / 32, kb = r / nblk, nb = r % nblk; transpose_item(w_in, DIN, (bf16*)((char*)Wb + WO_IN), D, 0, 32 * nb, 64 * kb, 32 * nb, scr, F.lane); continue; } r -= I_IN;
            if (r < I_UPA) { const int nblk = D / 32, kb = r / nblk, nb = r % nblk; transpose_item(w_upa, D, (bf16*)((char*)Wb + WO_UP), D, 0, 32 * nb, 64 * kb, 32 * nb, scr, F.lane); continue; } r -= I_UPA;
            if (r < I_UPB) { const int nblk = D / 32, kb = r / nblk, nb = r % nblk; transpose_item(w_upb, D, (bf16*)((char*)Wb + WO_UP), D, HGW, 32 * nb, 64 * kb, 32 * nb, scr, F.lane); continue; } r -= I_UPB;
            { const int nblk = D / 32, kb = r / nblk, nb = r % nblk; transpose_item(w_out, D, (bf16*)((char*)Wb + WO_OUT), D, 0, 32 * nb, 64 * kb, 32 * nb, scr, F.lane); }
        }
    }
    if (which & 2) {
        const float* w_g = KA->in[16] + (size_t)l * D * DFF; const float* w_u = KA->in[17] + (size_t)l * D * DFF; const float* w_d = KA->in[18] + (size_t)l * DFF * D;
        for (int it = gw; it < I_G + I_U + I_D; it += NGW) {
            int r = it;
            if (r < I_G) { const int nblk = DFF / 32, kb = r / nblk, nb = r % nblk, f0 = 32 * nb; transpose_item(w_g, DFF, (bf16*)((char*)Wb + WO_GU), D, 0, 256 * (f0 / 128) + (f0 % 128), 64 * kb, f0, scr, F.lane); continue; } r -= I_G;
            if (r < I_U) { const int nblk = DFF / 32, kb = r / nblk, nb = r % nblk, f0 = 32 * nb; transpose_item(w_u, DFF, (bf16*)((char*)Wb + WO_GU), D, 0, 256 * (f0 / 128) + 128 + (f0 % 128), 64 * kb, f0, scr, F.lane); continue; } r -= I_U;
            { const int nblk = D / 32, kb = r / nblk, nb = r % nblk; transpose_item(w_d, D, (bf16*)((char*)Wb + WO_DN), DFF, 0, 32 * nb, 64 * kb, 32 * nb, scr, F.lane); }
        }
    }
    __syncthreads();
}
__device__ __forceinline__ void rms_row_to_bf16(int lane, const float* xrow, const float* gain, bf16* orow) {
    const GAS f32x4* xr = (const GAS f32x4*)xrow + lane; const GAS f32x4* gr = (const GAS f32x4*)gain + lane;
    f32x4 v[4]; float s2 = 0.f;
#pragma unroll
    for (int j = 0; j < 4; ++j) { v[j] = xr[64 * j]; s2 += (v[j].x * v[j].x + v[j].y * v[j].y) + (v[j].z * v[j].z + v[j].w * v[j].w); }
    const float rstd = 1.f / sqrtf(wave_sum(s2) * (1.f / D) + EPS);
    GAS unsigned long long* o8 = (GAS unsigned long long*)orow + lane;
#pragma unroll
    for (int j = 0; j < 4; ++j) { const f32x4 g = gr[64 * j]; o8[64 * j] = (unsigned long long)pk2(v[j].x * rstd * g.x, v[j].y * rstd * g.y) | ((unsigned long long)pk2(v[j].z * rstd * g.z, v[j].w * rstd * g.w) << 32); }
}

template <class Epi>
__device__ __forceinline__ void naive_gemm(Frame& F, const bf16* A, int lda, const bf16* Bt, int ldb, int Mr, int Nc, int K, int ksplit, const Epi& E) {
    LAS float* As = (LAS float*)F.lds; LAS float* Bs = As + 64 * 33;
    const int tid = F.tid, ty = tid >> 4, tx = tid & 15;
    const int ntn = Nc / 64, ntm = Mr / 64;
    for (int tile = F.vcu; tile < ntm * ntn; tile += F.G) {
        const int tm = tile / ntn, tn = tile % ntn;
        float a0[2][4], a1[2][4];
#pragma unroll
        for (int i = 0; i < 2; ++i)
#pragma unroll
            for (int j = 0; j < 4; ++j) { a0[i][j] = 0.f; a1[i][j] = 0.f; }
        for (int k0 = 0; k0 < K; k0 += 32) {
            { const int r = tid >> 3, c4 = (tid & 7) * 4;
              const ushort4 av = *(const ushort4*)(A + (size_t)(tm * 64 + r) * lda + k0 + c4);
              const ushort4 bv = *(const ushort4*)(Bt + (size_t)(tn * 64 + r) * ldb + k0 + c4);
              As[r * 33 + c4 + 0] = bf2f(av.x); As[r * 33 + c4 + 1] = bf2f(av.y); As[r * 33 + c4 + 2] = bf2f(av.z); As[r * 33 + c4 + 3] = bf2f(av.w);
              Bs[r * 33 + c4 + 0] = bf2f(bv.x); Bs[r * 33 + c4 + 1] = bf2f(bv.y); Bs[r * 33 + c4 + 2] = bf2f(bv.z); Bs[r * 33 + c4 + 3] = bf2f(bv.w); }
            __syncthreads();
            if (k0 < ksplit) {
#pragma unroll 8
                for (int kk = 0; kk < 32; ++kk) { const float x0 = As[(2 * ty) * 33 + kk], x1 = As[(2 * ty + 1) * 33 + kk];
#pragma unroll
                    for (int j = 0; j < 4; ++j) { const float b = Bs[(4 * tx + j) * 33 + kk]; a0[0][j] += x0 * b; a0[1][j] += x1 * b; } }
            } else {
#pragma unroll 8
                for (int kk = 0; kk < 32; ++kk) { const float x0 = As[(2 * ty) * 33 + kk], x1 = As[(2 * ty + 1) * 33 + kk];
#pragma unroll
                    for (int j = 0; j < 4; ++j) { const float b = Bs[(4 * tx + j) * 33 + kk]; a1[0][j] += x0 * b; a1[1][j] += x1 * b; } }
            }
            __syncthreads();
        }
#pragma unroll
        for (int i = 0; i < 2; ++i)
#pragma unroll
            for (int j = 0; j < 4; ++j) E(tm * 64 + 2 * ty + i, tn * 64 + 4 * tx + j, a0[i][j], a1[i][j]);
    }
}

__device__ __forceinline__ float lower_bound(const float* lbp, int l, int c) {
    if (l == 0) return 0.f;
    const float b0 = lbp[c], b1 = lbp[HGW + c], mx = fmaxf(b0, b1), e0 = __expf(b0 - mx), e1 = __expf(b1 - mx);
    return e1 / (e0 + e1);
}
struct EpiMixIn {
    unsigned char* ws; const float* lbp; int l;
    __device__ __forceinline__ void operator()(int m, int n, float v, float) const {
        const int seg = n >> 9, c = n & 511; const size_t o = (size_t)m * 512 + c;
        if (seg == 0) ((bf16*)(ws + WS_QA))[o] = (bf16)f2bf(siluf_(v));
        else if (seg == 1) { const float lb = lower_bound(lbp, l, c); const float f = lb + (1.f - lb) * sigmoidf_(v); ((float*)(ws + WS_LF))[o] = __logf(f); }
        else if (seg == 2) ((bf16*)(ws + WS_VA))[o] = (bf16)f2bf(v);
        else if (seg == 3) ((bf16*)(ws + WS_GA))[o] = (bf16)f2bf(siluf_(v));
        else if (seg == 4) ((bf16*)(ws + WS_QB))[o] = (bf16)f2bf(v * C2);
        else if (seg == 5) ((bf16*)(ws + WS_KB))[o] = (bf16)f2bf(v);
        else ((bf16*)(ws + WS_VB))[o] = (bf16)f2bf(v);
    }
};
struct EpiGate { bf16* G; __device__ __forceinline__ void operator()(int m, int n, float v, float) const { G[(size_t)m * NGATE + n] = (bf16)f2bf(sigmoidf_(v)); } };
struct EpiMerge { const bf16* G; bf16* O; __device__ __forceinline__ void operator()(int m, int n, float v0, float v1) const {
    const float ga = bf2f(G[(size_t)m * NGATE + n]), gb = bf2f(G[(size_t)m * NGATE + D + n]); O[(size_t)m * D + n] = (bf16)f2bf(ga * v0 + gb * v1); } };
struct EpiF32 { float* C; __device__ __forceinline__ void operator()(int m, int n, float v, float) const { C[(size_t)m * D + n] = v; } };
struct EpiG { bf16* FFp; __device__ __forceinline__ void operator()(int m, int n, float v, float) const { const int pn = n >> 8, j = n & 255; if (j < 128) FFp[(size_t)m * DFF + pn * 128 + j] = (bf16)f2bf(siluf_(v)); } };
struct EpiU { bf16* FFp; __device__ __forceinline__ void operator()(int m, int n, float v, float) const { const int pn = n >> 8, j = n & 255; if (j >= 128) { bf16* p = FFp + (size_t)m * DFF + pn * 128 + (j - 128); *p = (bf16)f2bf(bf2f(*p) * v); } } };

__device__ __forceinline__ void naive_res_norm(Frame& F, const float* tmp, const float* base, float* out, const float* g1, const float* g2, bf16* xn) {
    const int gw = F.vcu * NWAVES + F.wave, NGW = F.G * NWAVES, lane = F.lane;
    for (int m = gw; m < M; m += NGW) {
        const GAS f32x4* tr = (const GAS f32x4*)(tmp + (size_t)m * D) + lane; const GAS f32x4* br = (const GAS f32x4*)(base + (size_t)m * D) + lane;
        f32x4 v[4]; float s2 = 0.f;
#pragma unroll
        for (int j = 0; j < 4; ++j) { v[j] = tr[64 * j]; s2 += (v[j].x * v[j].x + v[j].y * v[j].y) + (v[j].z * v[j].z + v[j].w * v[j].w); }
        const float rstd = 1.f / sqrtf(wave_sum(s2) * (1.f / D) + EPS);
        float t2 = 0.f;
#pragma unroll
        for (int j = 0; j < 4; ++j) { const f32x4 g = ((const GAS f32x4*)g1 + lane)[64 * j]; const f32x4 b = br[64 * j]; v[j] = b + v[j] * rstd * g; t2 += (v[j].x * v[j].x + v[j].y * v[j].y) + (v[j].z * v[j].z + v[j].w * v[j].w); }
        GAS f32x4* orow = (GAS f32x4*)(out + (size_t)m * D) + lane;
#pragma unroll
        for (int j = 0; j < 4; ++j) orow[64 * j] = v[j];
        if (g2) {
            const float rstd2 = 1.f / sqrtf(wave_sum(t2) * (1.f / D) + EPS);
            GAS unsigned long long* o8 = (GAS unsigned long long*)(xn + (size_t)m * D) + lane;
#pragma unroll
            for (int j = 0; j < 4; ++j) { const f32x4 g = ((const GAS f32x4*)g2 + lane)[64 * j]; o8[64 * j] = (unsigned long long)pk2(v[j].x * rstd2 * g.x, v[j].y * rstd2 * g.y) | ((unsigned long long)pk2(v[j].z * rstd2 * g.z, v[j].w * rstd2 * g.w) << 32); }
        }
    }
}


__device__ __forceinline__ void naive_attention(Frame& F) {
    LAS float* Ks = (LAS float*)F.lds; LAS float* Vs = Ks + 16 * 64;
    const bf16* QB = (const bf16*)(KA->ws + WS_QB); const bf16* KB = (const bf16*)(KA->ws + WS_KB); const bf16* VB = (const bf16*)(KA->ws + WS_VB); bf16* OB = (bf16*)(KA->ws + WS_OB);
    const int tid = F.tid;
    for (int item = F.vcu; item < 2 * 4 * 2 * 4 * 16; item += F.G) {
        const int rb = 15 - (item >> 6), rest = item & 63, b = rest >> 5, h = (rest >> 3) & 3, c = (rest >> 2) & 1, qt = rest & 3;
        const int i = rb * 512 + tid;
        const size_t rowq = (size_t)b * SEQ + i;
        const float slope2 = exp2f(-2.0f * (float)(h + 1)) * LOG2E;
        float q[64], o[32];
#pragma unroll
        for (int d = 0; d < 64; d += 4) { const ushort4 v = *(const ushort4*)(QB + rowq * 512 + h * 128 + c * 64 + d); q[d] = bf2f(v.x); q[d + 1] = bf2f(v.y); q[d + 2] = bf2f(v.z); q[d + 3] = bf2f(v.w); }
#pragma unroll
        for (int e = 0; e < 32; ++e) o[e] = 0.f;
        float mrun = -INFINITY, lrun = 0.f;
        const int nkt = (rb * 512 + 512) / 16;
        for (int kt = 0; kt < nkt; ++kt) {
            __syncthreads();
            { const int r = (tid >> 4) & 15, c4 = (tid & 15) * 4; const size_t rowk = (size_t)b * SEQ + kt * 16 + r;
              if (tid < 256) { const ushort4 kv = *(const ushort4*)(KB + rowk * 512 + h * 128 + c * 64 + c4);
                Ks[r * 64 + c4] = bf2f(kv.x); Ks[r * 64 + c4 + 1] = bf2f(kv.y); Ks[r * 64 + c4 + 2] = bf2f(kv.z); Ks[r * 64 + c4 + 3] = bf2f(kv.w); }
              else if (c4 < 32) { const ushort4 vv = *(const ushort4*)(VB + rowk * 512 + h * 128 + qt * 32 + c4);
                Vs[r * 32 + c4] = bf2f(vv.x); Vs[r * 32 + c4 + 1] = bf2f(vv.y); Vs[r * 32 + c4 + 2] = bf2f(vv.z); Vs[r * 32 + c4 + 3] = bf2f(vv.w); } }
            __syncthreads();
            if (kt * 16 > i) continue;
#pragma unroll 1
            for (int j = 0; j < 16; ++j) { float acc = 0.f;
#pragma unroll
                for (int d = 0; d < 64; ++d) acc += q[d] * Ks[j * 64 + d];
                const int kj = kt * 16 + j; acc -= slope2 * (float)(i - kj); const float sj = (kj <= i) ? acc : -INFINITY;
                const float mnew = fmaxf(mrun, sj), alpha = exp2f(mrun - mnew), p = exp2f(sj - mnew);
                lrun = lrun * alpha + p;
#pragma unroll
                for (int e = 0; e < 32; ++e) o[e] = o[e] * alpha + p * Vs[j * 32 + e];
                mrun = mnew; }
        }
        const float inv = 1.f / lrun;
        bf16* op = OB + (size_t)c * M * 512 + rowq * 512 + h * 128 + qt * 32;
#pragma unroll
        for (int e = 0; e < 32; e += 2) *(unsigned*)(op + e) = pk2(o[e] * inv, o[e + 1] * inv);
    }
}

__device__ __forceinline__ void combine_attention(Frame& F, const float* subln, float lam, float lam_init) {
    const bf16* OB = (const bf16*)(KA->ws + WS_OB); bf16* YAB = (bf16*)(KA->ws + WS_YAB);
    const int gw = F.vcu * NWAVES + F.wave, NGW = F.G * NWAVES, lane = F.lane;
    for (int m = gw; m < M; m += NGW) {
        const v4u a = *(const GAS v4u*)(OB + (size_t)m * 512 + lane * 8), b = *(const GAS v4u*)(OB + (size_t)M * 512 + (size_t)m * 512 + lane * 8);
        float y[8]; float s2 = 0.f;
#pragma unroll
        for (int j = 0; j < 4; ++j) { const unsigned ua = a[j], ub = b[j];
            y[2 * j] = bf2f((unsigned short)(ua & 0xffff)) - lam * bf2f((unsigned short)(ub & 0xffff)); y[2 * j + 1] = bf2f((unsigned short)(ua >> 16)) - lam * bf2f((unsigned short)(ub >> 16));
            s2 += y[2 * j] * y[2 * j] + y[2 * j + 1] * y[2 * j + 1]; }
#pragma unroll
        for (int o = 1; o < 16; o <<= 1) s2 += __shfl_xor(s2, o);
        const float rstd = (1.f - lam_init) / sqrtf(s2 * (1.f / 128.f) + EPS);
        const int e0 = (lane & 15) * 8; v4u w;
#pragma unroll
        for (int j = 0; j < 4; ++j) w[j] = pk2(y[2 * j] * rstd * subln[e0 + 2 * j], y[2 * j + 1] * rstd * subln[e0 + 2 * j + 1]);
        *(GAS v4u*)(YAB + (size_t)m * D + 512 + lane * 8) = w;
    }
}

__device__ __forceinline__ void naive_hgrn(Frame& F, const float* outgain) {
    if (F.vcu >= BATCH * HGH) return;
    const int b = F.vcu >> 2, h = F.vcu & 3, tid = F.tid, dv = tid & 127, dq = tid >> 7;
    LAS float* qs = (LAS float*)F.lds; LAS float* fs = qs + 16 * 128; LAS float* ks = fs + 16 * 128; LAS float* os = ks + 16 * 128;
    const bf16* QA = (const bf16*)(KA->ws + WS_QA); const float* LF = (const float*)(KA->ws + WS_LF); const bf16* VA = (const bf16*)(KA->ws + WS_VA); const bf16* GA = (const bf16*)(KA->ws + WS_GA); bf16* YAB = (bf16*)(KA->ws + WS_YAB);
    float S[32];
#pragma unroll
    for (int d = 0; d < 32; ++d) S[d] = 0.f;
    for (int t0 = 0; t0 < SEQ; t0 += 16) {
        __syncthreads();
        { const int r = tid >> 5, c4 = (tid & 31) * 4; const size_t row = (size_t)b * SEQ + t0 + r;
          const ushort4 qv = *(const ushort4*)(QA + row * 512 + h * 128 + c4); const f32x4 lf = *(const f32x4*)(LF + row * 512 + h * 128 + c4);
          qs[r * 128 + c4] = bf2f(qv.x); qs[r * 128 + c4 + 1] = bf2f(qv.y); qs[r * 128 + c4 + 2] = bf2f(qv.z); qs[r * 128 + c4 + 3] = bf2f(qv.w);
#pragma unroll
          for (int j = 0; j < 4; ++j) { const float f = __expf(lf[j]); fs[r * 128 + c4 + j] = f; ks[r * 128 + c4 + j] = 1.f - f; } }
        __syncthreads();
        for (int r = 0; r < 16; ++r) {
            const float v = bf2f(VA[((size_t)b * SEQ + t0 + r) * 512 + h * 128 + dv]);
            float o = 0.f;
#pragma unroll
            for (int d = 0; d < 32; ++d) { const int dk = r * 128 + 32 * dq + d; S[d] = fs[dk] * S[d] + ks[dk] * v; o += S[d] * qs[dk]; }
            os[(r * 4 + dq) * 128 + dv] = o;
        }
        __syncthreads();
        {
#pragma unroll
          for (int rr = 0; rr < 2; ++rr) { const int r = 2 * F.wave + rr;
              const float o0 = (os[(r * 4 + 0) * 128 + F.lane] + os[(r * 4 + 1) * 128 + F.lane]) + (os[(r * 4 + 2) * 128 + F.lane] + os[(r * 4 + 3) * 128 + F.lane]);
              const float o1 = (os[(r * 4 + 0) * 128 + 64 + F.lane] + os[(r * 4 + 1) * 128 + 64 + F.lane]) + (os[(r * 4 + 2) * 128 + 64 + F.lane] + os[(r * 4 + 3) * 128 + 64 + F.lane]);
              const float rstd = 1.f / sqrtf(wave_sum(o0 * o0 + o1 * o1) * (1.f / 128.f) + EPS); const size_t row = (size_t)b * SEQ + t0 + r;
              const float g0 = bf2f(GA[row * 512 + h * 128 + F.lane]), g1 = bf2f(GA[row * 512 + h * 128 + 64 + F.lane]);
              YAB[row * D + h * 128 + F.lane] = (bf16)f2bf(o0 * rstd * outgain[F.lane] * g0); YAB[row * D + h * 128 + 64 + F.lane] = (bf16)f2bf(o1 * rstd * outgain[64 + F.lane] * g1); } }
    }
}

__global__ void __launch_bounds__(NTHREADS, 2) hybrid_fwd(Args args) {
    extern __shared__ __attribute__((aligned(16))) unsigned char lds[];
    Frame F;
    F.lds = (LAS unsigned char*)lds; F.ldsg = lds;
    F.MISC = (volatile LAS unsigned*)(F.lds + MISC_OFF);
    F.tid = threadIdx.x; F.lane = F.tid & 63; F.wave = __builtin_amdgcn_readfirstlane(F.tid >> 6);
    F.G = gridDim.x; { const int bx = blockIdx.x; F.vcu = (F.G % 8 == 0) ? (bx % 8) * (F.G / 8) + bx / 8 : bx; }
    F.ctl = (gu32*)(KA->ws + WS_CTL);
    for (int u = F.tid; u < (LDS_BYTES - LDSCTL_OFF) / 4; u += NTHREADS) ((LAS unsigned*)(F.lds + LDSCTL_OFF))[u] = 0u;
    __syncthreads();
    XcdBarrier bar = xcd_barrier_post((unsigned*)(F.ctl + CW_BAR), F.MISC + 8);
#define GRID_BAR() xcd_barrier(bar)
#define ws (KA->ws)
#define x_in (KA->in[0])
#define xres (KA->out)
#define Wb ((bf16*)(ws + WS_W))
#define XN ((bf16*)(ws + WS_XN))

    convert_weights(F, 0, 3);
    { const int gw = F.vcu * NWAVES + F.wave, NGW = F.G * NWAVES;
      for (int m = gw; m < M; m += NGW) rms_row_to_bf16(F.lane, x_in + (size_t)m * D, KA->in[2], XN + (size_t)m * D); }
    GRID_BAR();

    for (int l = 0; l < DEPTH; ++l) {
        const float lam_init = 0.8f - 0.6f * expf(-0.3f * (float)l);
        float lam;
        { float s1 = 0.f, s2 = 0.f;
          for (int i = 0; i < DQK; ++i) { s1 += KA->in[9][l * DQK + i] * KA->in[10][l * DQK + i]; s2 += KA->in[11][l * DQK + i] * KA->in[12][l * DQK + i]; }
          lam = expf(s1) - expf(s2) + lam_init; }
        const float* base = (l == 0) ? x_in : xres;

        if (l == 1) convert_weights(F, 1, 2);
        { EpiMixIn E{ws, KA->in[1], l}; naive_gemm(F, XN, D, (const bf16*)((const char*)Wb + WO_IN), D, M, NMIX, D, D, E); }
        GRID_BAR();

        naive_hgrn(F, KA->in[7] + l * HGDV);
        naive_attention(F);
        GRID_BAR();

        combine_attention(F, KA->in[8] + l * DADV, lam, lam_init);
        { EpiGate E{(bf16*)(ws + WS_GATE)}; naive_gemm(F, XN, D, (const bf16*)((const char*)Wb + WO_IN) + (size_t)NMIX * D, D, M, NGATE, D, D, E); }
        GRID_BAR();

        { EpiMerge E{(const bf16*)(ws + WS_GATE), (bf16*)(ws + WS_MERGED)}; naive_gemm(F, (const bf16*)(ws + WS_YAB), D, (const bf16*)((const char*)Wb + WO_UP), D, M, D, D, HGW, E); }
        GRID_BAR();

        { EpiF32 E{(float*)(ws + WS_TMP1)}; naive_gemm(F, (const bf16*)(ws + WS_MERGED), D, (const bf16*)((const char*)Wb + WO_OUT), D, M, D, D, D, E); }
        GRID_BAR();
        naive_res_norm(F, (const float*)(ws + WS_TMP1), base, xres, KA->in[3] + l * D, KA->in[4] + l * D, XN);
        GRID_BAR();

        {
            EpiG Eg{(bf16*)(ws + WS_FF)}; EpiU Eu{(bf16*)(ws + WS_FF)};
            naive_gemm(F, XN, D, (const bf16*)((const char*)Wb + WO_GU), D, M, 2 * DFF, D, D, Eg);
            GRID_BAR();
            naive_gemm(F, XN, D, (const bf16*)((const char*)Wb + WO_GU), D, M, 2 * DFF, D, D, Eu);
        }
        GRID_BAR();
        if (l == 0) convert_weights(F, 1, 1);

        { EpiF32 E{(float*)(ws + WS_TMP2)}; naive_gemm(F, (const bf16*)(ws + WS_FF), DFF, (const bf16*)((const char*)Wb + WO_DN), DFF, M, D, DFF, DFF, E); }
        GRID_BAR();
        naive_res_norm(F, (const float*)(ws + WS_TMP2), xres, xres, KA->in[5] + l * D, (l + 1 < DEPTH) ? KA->in[2] + (l + 1) * D : nullptr, XN);
        if (l + 1 < DEPTH) GRID_BAR();
    }
}

#undef ws
#undef x_in
#undef xres
#undef Wb
#undef XN
extern "C" void kernel_launch(void* const* d_in, const int* in_sizes, int n_in, void* d_out, int out_size, void* d_ws, size_t ws_size, hipStream_t stream) {
    static int grid = 0;
    if (grid == 0) {
        if (n_in != 19 || in_sizes[0] != M * D || out_size != M * D || ws_size < WS_END) { fprintf(stderr, "kernel_launch: unexpected problem (n_in %d, in0 %d, out %d, ws %zu); nothing launched\n", n_in, n_in > 0 ? in_sizes[0] : -1, out_size, ws_size); grid = -1; return; }
        int dev = 0, cus = 0, per_cu = 0;
        if (hipGetDevice(&dev) != hipSuccess || hipDeviceGetAttribute(&cus, hipDeviceAttributeMultiprocessorCount, dev) != hipSuccess) { fprintf(stderr, "kernel_launch: device query failed\n"); grid = -1; return; }
        if (hipFuncSetAttribute((const void*)hybrid_fwd, hipFuncAttributeMaxDynamicSharedMemorySize, LDS_BYTES) != hipSuccess) { fprintf(stderr, "kernel_launch: hipFuncSetAttribute failed\n"); grid = -1; return; }
        if (hipOccupancyMaxActiveBlocksPerMultiprocessor(&per_cu, (const void*)hybrid_fwd, NTHREADS, LDS_BYTES) != hipSuccess || per_cu < 1) { fprintf(stderr, "kernel_launch: occupancy query reports %d workgroups per CU\n", per_cu); }
        (void)hipGetLastError();
        grid = cus;
    }
    if (grid < 0) return;
    if (hipMemsetAsync((char*)d_ws + WS_CTL, 0, CTL_ZERO_BYTES, stream) != hipSuccess) { fprintf(stderr, "kernel_launch: memset failed\n"); return; }
    Args a{};
    for (int i = 0; i < 19; ++i) a.in[i] = (const float*)d_in[i];
    a.out = (float*)d_out; a.ws = (unsigned char*)d_ws;
    hipLaunchKernelGGL(hybrid_fwd, dim3(grid), dim3(NTHREADS), LDS_BYTES, stream, a);
    const hipError_t le = hipPeekAtLastError();
    if (le != hipSuccess) fprintf(stderr, "kernel_launch: launch failed: %s\n", hipGetErrorName(le));
}
```
